# Optimizing an MI355X kernel written in HIP

```python
import jax, jax.numpy as jnp
from jax import lax
import numpy as np

D_MODEL = 1024
BATCH = 1
SEQ = 16384
DEPTH = 2
DEC_BATCH = 32
DEC_SEQ = 64
PAST_LEN = 4096

CHUNK = 64
N_META = 16
POOL_WINDOWS = (2, 4, 8, 16)
N_POOL_GROUPS = 4
POOL_GROUP = D_MODEL // N_POOL_GROUPS
POOL_STATE = max(POOL_WINDOWS) - 1
CONV_WIDTH = 3
D_FF = 4 * D_MODEL
EPS = 1e-5

kernel_name = "hybrid_pool_shortconv_stream_step"


def rmsnorm(x, g):
    xf = x.astype(jnp.float32)
    y = xf * lax.rsqrt(jnp.mean(xf * xf, axis=-1, keepdims=True) + EPS)
    return (y * g.astype(jnp.float32)).astype(x.dtype)


def pool_mixer(h, hist, pos0, w_pool, pool_scale):
    bsz, L, _ = h.shape
    P = hist.shape[1]
    u = jnp.concatenate([hist.astype(h.dtype), h], axis=1)
    N = P + L
    c = jnp.cumsum(u.astype(jnp.float32), axis=1)
    pos = pos0 + jnp.arange(L, dtype=jnp.int32)
    hf = h.astype(jnp.float32)
    diffs = []
    for g, w in enumerate(POOL_WINDOWS):
        sl = slice(g * POOL_GROUP, (g + 1) * POOL_GROUP)
        cpad = jnp.pad(c[..., sl], ((0, 0), (w, 0), (0, 0)))
        s = cpad[:, P + w:] - cpad[:, P:N]
        cnt = jnp.minimum(pos + 1, w).astype(jnp.float32)
        diffs.append(s / cnt[None, :, None] - hf[..., sl])
    d = jnp.stack(diffs, axis=2).astype(h.dtype)
    out = jnp.einsum('blgc,gcd->blgd', d, w_pool).reshape(bsz, L, D_MODEL)
    return out * pool_scale, u[:, N - POOL_STATE:]


def conv_mixer(h, hist, w_conv_in, conv_w, w_conv_out):
    L = h.shape[1]
    z = h @ w_conv_in
    b, c, v = jnp.split(z, 3, axis=-1)
    u = c * v
    uf = jnp.concatenate([hist.astype(u.dtype), u], axis=1)
    y = conv_w[0] * uf[:, 0:L]
    for k in range(1, CONV_WIDTH):
        y = y + conv_w[k] * uf[:, k:k + L]
    return (b * y) @ w_conv_out, uf[:, -(CONV_WIDTH - 1):]


def sqrelu_mlp(h, w_up, w_down):
    a = jax.nn.relu(h @ w_up)
    return (a * a) @ w_down


def trunk(x, pool_hist, conv_hist, pos0, norm_mix, norm_mlp, norm_final,
          w_pool, pool_scale, w_conv_in, conv_w, w_conv_out, w_up, w_down):
    new_pool = None
    new_conv = None
    for i in range(DEPTH):
        h = rmsnorm(x, norm_mix[i])
        if i % 2 == 0:
            dx, new_pool = pool_mixer(h, pool_hist, pos0, w_pool, pool_scale)
        else:
            dx, new_conv = conv_mixer(h, conv_hist, w_conv_in, conv_w, w_conv_out)
        x = x + dx
        x = x + sqrelu_mlp(rmsnorm(x, norm_mlp[i]), w_up[i], w_down[i])
    return rmsnorm(x, norm_final), new_pool, new_conv


def setup_inputs(seed: int = 0) -> dict:
    key = jax.random.key(seed)
    ks = jax.random.split(key, 16)
    f32 = jnp.float32
    x_prompt = jax.random.normal(ks[0], (BATCH, SEQ, D_MODEL), f32)
    x_sample = jax.random.normal(ks[1], (DEC_BATCH, DEC_SEQ, D_MODEL), f32)
    state_pool = jax.random.normal(ks[2], (DEC_BATCH, POOL_STATE, D_MODEL), f32)
    state_conv = jax.random.normal(ks[3], (DEC_BATCH, CONV_WIDTH - 1, D_MODEL), f32)
    meta_tokens = jax.random.normal(ks[4], (N_META, D_MODEL), f32)
    norm_mix = 1.0 + 0.02 * jax.random.normal(ks[5], (DEPTH, D_MODEL), f32)
    norm_mlp = 1.0 + 0.02 * jax.random.normal(ks[6], (DEPTH, D_MODEL), f32)
    norm_final = 1.0 + 0.02 * jax.random.normal(ks[7], (D_MODEL,), f32)
    w_pool = jax.random.normal(ks[8], (N_POOL_GROUPS, POOL_GROUP, POOL_GROUP), f32) * POOL_GROUP ** -0.5
    pool_scale = 1.0 + 0.02 * jax.random.normal(ks[9], (D_MODEL,), f32)
    w_conv_in = jax.random.normal(ks[10], (D_MODEL, 3 * D_MODEL), f32) * D_MODEL ** -0.5
    conv_w = jax.random.normal(ks[11], (CONV_WIDTH, D_MODEL), f32) * CONV_WIDTH ** -0.5
    w_conv_out = jax.random.normal(ks[12], (D_MODEL, D_MODEL), f32) * D_MODEL ** -0.5
    w_up = jax.random.normal(ks[13], (DEPTH, D_MODEL, D_FF), f32) * D_MODEL ** -0.5
    w_down = jax.random.normal(ks[14], (DEPTH, D_FF, D_MODEL), f32) * D_FF ** -0.5
    return {"x_prompt": x_prompt, "x_sample": x_sample,
            "state_pool": state_pool, "state_conv": state_conv,
            "meta_tokens": meta_tokens, "norm_mix": norm_mix, "norm_mlp": norm_mlp,
            "norm_final": norm_final, "w_pool": w_pool, "pool_scale": pool_scale,
            "w_conv_in": w_conv_in, "conv_w": conv_w, "w_conv_out": w_conv_out,
            "w_up": w_up, "w_down": w_down}


def reference(x_prompt, x_sample, state_pool, state_conv, meta_tokens, norm_mix, norm_mlp,
              norm_final, w_pool, pool_scale, w_conv_in, conv_w, w_conv_out, w_up, w_down):
    bsz = x_prompt.shape[0]
    meta = jnp.broadcast_to(meta_tokens.astype(x_prompt.dtype)[None], (bsz, N_META, D_MODEL))
    xp = jnp.concatenate([meta, x_prompt], axis=1)
    pool_hist0 = jnp.zeros((bsz, 0, D_MODEL), x_prompt.dtype)
    conv_hist0 = jnp.zeros((bsz, CONV_WIDTH - 1, D_MODEL), x_prompt.dtype)
    yp, new_pool_prompt, new_conv_prompt = trunk(
        xp, pool_hist0, conv_hist0, 0, norm_mix, norm_mlp, norm_final,
        w_pool, pool_scale, w_conv_in, conv_w, w_conv_out, w_up, w_down)
    y_prompt = yp[:, N_META:]
    y_sample, new_pool_sample, new_conv_sample = trunk(
        x_sample, state_pool, state_conv, PAST_LEN, norm_mix, norm_mlp, norm_final,
        w_pool, pool_scale, w_conv_in, conv_w, w_conv_out, w_up, w_down)
    return (y_prompt, y_sample, new_pool_prompt, new_pool_sample, new_conv_prompt, new_conv_sample)
```

```cpp
#include <hip/hip_runtime.h>
#include <hip/hip_cooperative_groups.h>
#include <cstdio>
#include <cstdint>
namespace cg = cooperative_groups;

constexpr int D = 1024, FF = 4096, NPROMPT = 16400  , NSAMP_B = 32, NSAMP_L = 64;
constexpr int T_ROWS = NPROMPT + NSAMP_B * NSAMP_L;
constexpr int M_PAD = 18688;
constexpr float EPS = 1e-5f;
constexpr size_t O_YP = 0, O_YS = 16384ull * 1024, O_NPP = O_YS + 2048ull * 1024, O_NPS = O_NPP + 15 * 1024, O_NCP = O_NPS + 32ull * 15 * 1024, O_NCS = O_NCP + 2 * 1024;

namespace pg8 {
#define PG8_LAS __attribute__((address_space(3)))
typedef unsigned short bf16_t;
typedef short bf16x8 __attribute__((ext_vector_type(8)));
typedef float f32x4 __attribute__((ext_vector_type(4)));
typedef unsigned u32x4 __attribute__((ext_vector_type(4)));
typedef unsigned u32x2 __attribute__((ext_vector_type(2)));
constexpr int BM = 256, BK = 64, HALF = 128, HTB = HALF * BK * 2, STAGE_BYTES = 8 * HTB, NXCD = 8, WGM = 8;

__host__ __device__ __forceinline__ int lds_byte(int r, int c) { const int st = (r >> 4) * 2 + (c >> 5), rr = r & 15, cc = c & 31, ob = rr * 64 + cc * 2; return st * 1024 + (ob ^ (((ob >> 9) & 1) << 5)); }
__host__ __device__ __forceinline__ void stage_rc(int b, int& R, int& C) { const int st = b / 1024, sb = b % 1024, swz = sb ^ (((sb >> 9) & 1) << 5); R = (st >> 1) * 16 + swz / 64; C = (st & 1) * 32 + (swz % 64) / 2; }
__host__ __device__ __forceinline__ int perm32(int rho) { const int n = rho >> 4, i = rho & 15; return 8 * (i >> 2) + 4 * n + (i & 3); }

struct Unit { int pm, pn; };
struct Gemm { const bf16_t* A; const bf16_t* Bt; int M, N, K, lda, ldb, a_pn_off; };

struct StaticOrder {
    int nM, nN, nwg, G, c;
    __device__ void init(int M, int N, int G_, int c_) { nM = M / BM; nN = N / BM; nwg = nM * nN; G = G_; c = c_; }
    __device__ bool next(int i, Unit& u) const {
        const long L = (long)i * G + c; if (L >= nwg) return false;
        int wgid = (int)L; { const int q = nwg / NXCD, r = nwg % NXCD, xcd = wgid % NXCD, off = wgid / NXCD; wgid = (xcd < r ? xcd * (q + 1) : r * (q + 1) + (xcd - r) * q) + off; }
        const int nig = WGM * nN, gid = wgid / nig, fm = gid * WGM, gsz = (nM - fm) < WGM ? (nM - fm) : WGM;
        u.pm = fm + ((wgid % nig) % gsz); u.pn = (wgid % nig) / gsz; return true;
    }
    __device__ __forceinline__ void a_ready(const Unit&) const {}
    __device__ __forceinline__ void done(const Unit&) const {}
};

__device__ __forceinline__ unsigned cvt_pk_bf16(float lo, float hi) { unsigned r; asm volatile("v_cvt_pk_bf16_f32 %0, %1, %2" : "=v"(r) : "v"(lo), "v"(hi)); return r; }


__device__ __forceinline__ float row_rstd(const float* SS, int row) {
    const f32x4* p = (const f32x4*)(SS + (size_t)row * 16);
    const f32x4 a = p[0], b = p[1], c = p[2], d = p[3];
    const float s = ((a[0] + a[1]) + (a[2] + a[3])) + ((b[0] + b[1]) + (b[2] + b[3])) + ((c[0] + c[1]) + (c[2] + c[3])) + ((d[0] + d[1]) + (d[2] + d[3]));
    return 1.0f / sqrtf(s * (1.0f / 1024.0f) + EPS);
}

template <int ACT> struct EpiScaleBf16 {
    static constexpr bool PERM = true, AFTER_DRAIN = false;
    bf16_t* O; int ldc; const float* SS;
    __device__ __forceinline__ void operator()(const f32x4 (&acc)[2][2][4][2], const Unit& u, int wr, int wc, int fr, int fq) const {
        const int row0 = u.pm * BM + wr * 64 + fr; const int col0 = u.pn * BM + wc * 32 + 8 * fq;
#pragma unroll
        for (int ai = 0; ai < 2; ++ai)
#pragma unroll
            for (int m = 0; m < 4; ++m) { const int row = row0 + ai * HALF + m * 16; const float rs = row_rstd(SS, row); bf16_t* rowp = O + (size_t)row * ldc + col0;
#pragma unroll
                for (int bj = 0; bj < 2; ++bj) { f32x4 v0 = acc[ai][bj][m][0] * rs, v1 = acc[ai][bj][m][1] * rs;
                    if (ACT == 1) {
#pragma unroll
                        for (int j = 0; j < 4; ++j) { const float a0 = fmaxf(v0[j], 0.f), a1 = fmaxf(v1[j], 0.f); v0[j] = a0 * a0; v1[j] = a1 * a1; } }
                    u32x4 w; w.x = cvt_pk_bf16(v0[0], v0[1]); w.y = cvt_pk_bf16(v0[2], v0[3]); w.z = cvt_pk_bf16(v1[0], v1[1]); w.w = cvt_pk_bf16(v1[2], v1[3]);
                    *(u32x4*)(rowp + bj * HALF) = w; } }
    }
};

template <bool FIRST> struct EpiRes {
    static constexpr bool PERM = false, AFTER_DRAIN = false;
    float* xmeta; float* dout; bf16_t* XB; float* SSo; const float* scale; const float* in_meta; const float* in_p; const float* in_s;
    __device__ __forceinline__ void operator()(const f32x4 (&acc)[2][2][4][2], const Unit& u, int wr, int wc, int fr, int fq) const {
        const int col0 = u.pn * BM + wc * 32 + 4 * fq;
        const unsigned loff = (unsigned)(fr * D + col0);
#pragma unroll
        for (int ai = 0; ai < 2; ++ai)
#pragma unroll
            for (int m = 0; m < 4; ++m) {
                const int rb = __builtin_amdgcn_readfirstlane(u.pm * BM + ai * HALF + wr * 64 + m * 16);
                const bool valid = rb < T_ROWS;
                float* xo = rb == 0 ? xmeta : dout + (size_t)(rb - 16) * D;
                const float* xi = FIRST ? (rb == 0 ? in_meta : (rb < NPROMPT ? in_p + (size_t)(rb - 16) * D : in_s + (size_t)(rb - NPROMPT) * D)) : xo;
                bf16_t* xb = XB + (size_t)rb * D; float ss = 0.f;
#pragma unroll
                for (int bj = 0; bj < 2; ++bj)
#pragma unroll
                    for (int n = 0; n < 2; ++n) { const unsigned o = loff + bj * HALF + n * 16;
                        f32x4 xv = (f32x4){0.f, 0.f, 0.f, 0.f}; if (valid) xv = *(const f32x4*)(xi + o);
                        f32x4 v = acc[ai][bj][m][n];
                        if (FIRST) v = v * *(const f32x4*)(scale + col0 + bj * HALF + n * 16);
                        v = v + xv;
                        if (valid) *(f32x4*)(xo + o) = v;
                        u32x2 w; w.x = cvt_pk_bf16(v[0], v[1]); w.y = cvt_pk_bf16(v[2], v[3]); *(u32x2*)(xb + o) = w;
                        ss += (v[0] * v[0] + v[1] * v[1]) + (v[2] * v[2] + v[3] * v[3]); }
                ss += __shfl_xor(ss, 16); ss += __shfl_xor(ss, 32);
                if (fq == 0) SSo[(size_t)(rb + fr) * 16 + u.pn * 4 + wc] = ss;
                asm volatile("" ::: "memory"); }
    }
};

template <class Epi, class Sched>
__device__ __forceinline__ void gemm_phase(PG8_LAS unsigned char* lds, const Gemm g, const Sched& S, const Epi& E) {
    int tid_ = threadIdx.x; asm volatile("" : "+v"(tid_));
    const int tid = tid_, wid = __builtin_amdgcn_readfirstlane(tid >> 6), lane = tid & 63, wr = wid >> 2, wc = wid & 3, fr = lane & 15, fq = lane >> 4;
    const int K = g.K, nt = K / BK;
    unsigned voffA[2], voffB[2];
#pragma unroll
    for (int i = 0; i < 2; ++i) { int R, C; stage_rc(tid * 16 + i * 8192, R, C); const int Rb = Epi::PERM ? ((R & ~31) + perm32(R & 31)) : R;
        voffA[i] = (unsigned)(R * g.lda + C) * 2u; voffB[i] = (unsigned)(Rb * g.ldb + C) * 2u; }
    const size_t kstep = (size_t)(BK * 2);
    const size_t hstepA = (size_t)HALF * g.lda * 2, tstepA = 2 * hstepA, hstepB = (size_t)HALF * g.ldb * 2, tstepB = 2 * hstepB, pnA = (size_t)g.a_pn_off * 2;
    const unsigned ldsw = (unsigned)wid * 1024u;
    const int aoff = lds_byte(wr * 64 + fr, fq * 8), boff = lds_byte(wc * 32 + fr, fq * 8);
#define PG8_SA(b, h) (((b) * 2 + (h)) * HTB)
#define PG8_SB(b, h) ((4 + (b) * 2 + (h)) * HTB)
#define PG8_STAGE(bufoff, gbase, voff) do { _Pragma("unroll") for (int _i = 0; _i < 2; ++_i) \
        __builtin_amdgcn_global_load_lds((const unsigned*)((const char*)(gbase) + (voff)[_i]), (PG8_LAS unsigned*)(lds + (bufoff) + ldsw + _i * 8192), 16, 0, 0); } while (0)
#define PG8_LDA(dst, b, h) do { _Pragma("unroll") for (int m = 0; m < 4; ++m) _Pragma("unroll") for (int k = 0; k < 2; ++k) dst[m][k] = *(const PG8_LAS bf16x8*)(lds + PG8_SA(b, h) + aoff + m * 2048 + k * 1024); } while (0)
#define PG8_LDB(dst, b, h) do { _Pragma("unroll") for (int n = 0; n < 2; ++n) _Pragma("unroll") for (int k = 0; k < 2; ++k) dst[n][k] = *(const PG8_LAS bf16x8*)(lds + PG8_SB(b, h) + boff + n * 2048 + k * 1024); } while (0)
#define PG8_MMA(ai, bj, At, Bt) do { __builtin_amdgcn_s_setprio(1); _Pragma("unroll") for (int m = 0; m < 4; ++m) _Pragma("unroll") for (int n = 0; n < 2; ++n) _Pragma("unroll") for (int k = 0; k < 2; ++k) \
        acc[ai][bj][m][n] = __builtin_amdgcn_mfma_f32_16x16x32_bf16(Bt[n][k], At[m][k], acc[ai][bj][m][n], 0, 0, 0); __builtin_amdgcn_s_setprio(0); } while (0)
#define PG8_WAIT_V(n) asm volatile("s_waitcnt vmcnt(" #n ")" ::: "memory")
#define PG8_WAIT_L(n) asm volatile("s_waitcnt lgkmcnt(" #n ")" ::: "memory")
#define PG8_BAR __builtin_amdgcn_s_barrier()
#define PG8_SCHED __builtin_amdgcn_sched_barrier(0)
    Unit cur, nxt; int ui = 0;
    if (!S.next(0, cur)) return;
    f32x4 acc[2][2][4][2];
#pragma unroll
    for (int a = 0; a < 2; ++a)
#pragma unroll
        for (int b = 0; b < 2; ++b)
#pragma unroll
            for (int m = 0; m < 4; ++m)
#pragma unroll
                for (int n = 0; n < 2; ++n) acc[a][b][m][n] = (f32x4){0.f, 0.f, 0.f, 0.f};
    bf16x8 At[4][2], B0[2][2], B1[2][2];
    const char* cA = (const char*)g.A + (size_t)cur.pm * tstepA + (size_t)cur.pn * pnA; const char* cB = (const char*)g.Bt + (size_t)cur.pn * tstepB;
    S.a_ready(cur);
    PG8_STAGE(PG8_SB(0, 0), cB, voffB); PG8_STAGE(PG8_SB(0, 1), cB + hstepB, voffB); PG8_STAGE(PG8_SA(0, 0), cA, voffA); PG8_STAGE(PG8_SA(0, 1), cA + hstepA, voffA);
    if (wr == 1) PG8_BAR;
    PG8_WAIT_V(2); PG8_BAR;
    PG8_STAGE(PG8_SB(1, 0), cB + kstep, voffB); PG8_STAGE(PG8_SA(1, 0), cA + kstep, voffA); PG8_STAGE(PG8_SB(1, 1), cB + hstepB + kstep, voffB);
    PG8_WAIT_V(6); PG8_BAR;
    for (;;) {
        const bool has_next = S.next(ui + 1, nxt);
        const char* nA = has_next ? (const char*)g.A + (size_t)nxt.pm * tstepA + (size_t)nxt.pn * pnA : cA; const char* nB = has_next ? (const char*)g.Bt + (size_t)nxt.pn * tstepB : cB;
        for (int t = 0; t < nt; t += 2) {
            const bool last = (t == nt - 2);
            const char* a1 = cA + (size_t)(t + 1) * kstep;
            const char* a2 = last ? nA : cA + (size_t)(t + 2) * kstep; const char* b2 = last ? nB : cB + (size_t)(t + 2) * kstep;
            const char* a3 = a2 + kstep; const char* b3 = b2 + kstep;
            if (last && has_next) S.a_ready(nxt);
            PG8_LDB(B0, 0, 0); PG8_LDB(B1, 0, 1); PG8_SCHED; PG8_LDA(At, 0, 0); PG8_STAGE(PG8_SA(1, 1), a1 + hstepA, voffA);
            PG8_WAIT_V(8); PG8_WAIT_L(0); PG8_BAR; PG8_MMA(0, 0, At, B0); PG8_MMA(0, 1, At, B1); PG8_BAR; PG8_SCHED;
            PG8_LDA(At, 0, 1); PG8_STAGE(PG8_SB(0, 0), b2, voffB); PG8_STAGE(PG8_SB(0, 1), b2 + hstepB, voffB); PG8_STAGE(PG8_SA(0, 0), a2, voffA);
            PG8_WAIT_V(8); PG8_WAIT_L(0); PG8_BAR; PG8_MMA(1, 0, At, B0); PG8_MMA(1, 1, At, B1); PG8_BAR; PG8_SCHED;
            PG8_LDB(B0, 1, 0); PG8_LDB(B1, 1, 1); PG8_SCHED; PG8_LDA(At, 1, 0); PG8_STAGE(PG8_SA(0, 1), a2 + hstepA, voffA);
            PG8_WAIT_V(8); PG8_WAIT_L(0); PG8_BAR; PG8_MMA(0, 0, At, B0); PG8_MMA(0, 1, At, B1); PG8_BAR; PG8_SCHED;
            PG8_LDA(At, 1, 1); PG8_STAGE(PG8_SB(1, 0), b3, voffB); PG8_STAGE(PG8_SB(1, 1), b3 + hstepB, voffB); PG8_STAGE(PG8_SA(1, 0), a3, voffA);
            PG8_WAIT_V(8); PG8_WAIT_L(0); PG8_BAR; PG8_MMA(1, 0, At, B0); PG8_MMA(1, 1, At, B1); PG8_BAR; PG8_SCHED;
        }
        if (wr == 0) PG8_BAR;
        E(acc, cur, wr, wc, fr, fq); S.done(cur);
        if (!has_next) break;
#pragma unroll
        for (int a = 0; a < 2; ++a)
#pragma unroll
            for (int b = 0; b < 2; ++b)
#pragma unroll
                for (int m = 0; m < 4; ++m)
#pragma unroll
                    for (int n = 0; n < 2; ++n) acc[a][b][m][n] = (f32x4){0.f, 0.f, 0.f, 0.f};
        cur = nxt; cA = nA; cB = nB; ++ui;
        if (wr == 1) PG8_BAR;
    }
    PG8_WAIT_V(0);
    PG8_BAR;
#undef PG8_SA
#undef PG8_SB
#undef PG8_STAGE
#undef PG8_LDA
#undef PG8_LDB
#undef PG8_MMA
#undef PG8_WAIT_V
#undef PG8_WAIT_L
#undef PG8_BAR
#undef PG8_SCHED
}
}

constexpr size_t MiB = 1u << 20;
constexpr size_t WS_CTL = 0;
constexpr size_t WS_SS = 1 * MiB;
constexpr size_t WS_XMETA = 3 * MiB;
constexpr size_t WS_WPOOL = 4 * MiB, WS_WCO = 5 * MiB, WS_WCI = 7 * MiB, WS_WUP = 13 * MiB, WS_WDN = 29 * MiB;
constexpr size_t WS_XB = 45 * MiB;
constexpr size_t WS_H = 82 * MiB;
constexpr size_t WS_G = WS_H + (size_t)M_PAD * 3072 * 2;
constexpr size_t WS_END = WS_H + (size_t)M_PAD * FF * 2;
static_assert(WS_XB + (size_t)M_PAD * D * 2 <= WS_H && WS_END <= 256 * MiB && WS_SS + (size_t)M_PAD * 64 <= WS_XMETA, "d_ws map");

constexpr int LDS_BYTES = 147456;
#define LAS __attribute__((address_space(3)))
typedef unsigned short bf16;
typedef float f32x4 __attribute__((ext_vector_type(4)));
typedef unsigned v4u __attribute__((ext_vector_type(4)));
typedef unsigned v2u __attribute__((ext_vector_type(2)));
#define LDS_WAIT() asm volatile("s_waitcnt lgkmcnt(0)" ::: "memory")
__device__ __forceinline__ unsigned f2bf(float f) { unsigned u = __builtin_bit_cast(unsigned, f); return (u + 0x7fffu + ((u >> 16) & 1u)) >> 16; }
__device__ __forceinline__ unsigned pk2(float lo, float hi) { return f2bf(lo) | (f2bf(hi) << 16); }
__device__ __forceinline__ float bf_lo(unsigned w) { return __builtin_bit_cast(float, w << 16); }
__device__ __forceinline__ float bf_hi(unsigned w) { return __builtin_bit_cast(float, w & 0xffff0000u); }
__device__ __forceinline__ float wave_sum(float v) {
#pragma unroll
    for (int o = 1; o < 64; o <<= 1) v += __shfl_xor(v, o);
    return v;
}

__device__ __forceinline__ void p0_transpose_item(const float* W, const float* gain, int K, int N, bf16* WT, LAS float* scr, int item, int lane) {
    const int nblk = N / 32, kb = item / nblk, nb = item % nblk, k0 = 64 * kb, n0 = 32 * nb;
#pragma unroll 8
    for (int i = 0; i < 32; ++i) { const int kk = 2 * i + (lane >> 5); float w = W[(size_t)(k0 + kk) * N + n0 + (lane & 31)]; if (gain) w *= gain[k0 + kk]; scr[kk * 33 + (lane & 31)] = w; }
    LDS_WAIT(); asm volatile("" ::: "memory");
    const int c = lane & 7;
#pragma unroll
    for (int j = 0; j < 4; ++j) { const int n = (lane >> 3) + 8 * j; const LAS float* s = scr + (8 * c) * 33 + n;
        v4u o; o.x = pk2(s[0 * 33], s[1 * 33]); o.y = pk2(s[2 * 33], s[3 * 33]); o.z = pk2(s[4 * 33], s[5 * 33]); o.w = pk2(s[6 * 33], s[7 * 33]);
        *(v4u*)(WT + (size_t)(n0 + n) * K + k0 + 8 * c) = o; }
    LDS_WAIT(); asm volatile("" ::: "memory");
}

struct Args { const float* in[15]; float* out; unsigned char* ws; };

__device__ __forceinline__ void pool_front_chunk(const Args& a, bf16* D0, int chunk, int lane) {
    const bool prompt = chunk < NPROMPT / 16;
    const int cc = chunk - NPROMPT / 16, sb = cc >> 2;
    const int p0 = prompt ? chunk * 16 : (cc & 3) * 16;
    const int frow0 = prompt ? chunk * 16 : NPROMPT + sb * 64 + p0;
    const float* g0p = a.in[5];
    f32x4 g0[4];
#pragma unroll
    for (int j = 0; j < 4; ++j) g0[j] = *(const f32x4*)(g0p + 4 * lane + 256 * j);
    f32x4 r0[2], r1[4], r2[8], r3[16];
#pragma unroll
    for (int i = 0; i < 2; ++i) r0[i] = (f32x4){0.f, 0.f, 0.f, 0.f};
#pragma unroll
    for (int i = 0; i < 4; ++i) r1[i] = (f32x4){0.f, 0.f, 0.f, 0.f};
#pragma unroll
    for (int i = 0; i < 8; ++i) r2[i] = (f32x4){0.f, 0.f, 0.f, 0.f};
#pragma unroll
    for (int i = 0; i < 16; ++i) r3[i] = (f32x4){0.f, 0.f, 0.f, 0.f};
    for (int aa = 0; aa < 2; ++aa) {
#pragma unroll
        for (int i = 0; i < 16; ++i) {
            const int s = aa * 16 + i;
            if (s < 31) {
                const int p = p0 + s - 15;
                f32x4 h[4];
                if (p < 0) {
                    if (prompt) {
#pragma unroll
                        for (int j = 0; j < 4; ++j) h[j] = (f32x4){0.f, 0.f, 0.f, 0.f};
                    } else {
                        const float* sp = a.in[2] + ((size_t)sb * 15 + (15 + p)) * D + 4 * lane;
#pragma unroll
                        for (int j = 0; j < 4; ++j) h[j] = *(const f32x4*)(sp + 256 * j);
                    }
                } else {
                    const float* xr = (prompt ? (p < 16 ? a.in[4] + (size_t)p * D : a.in[0] + (size_t)(p - 16) * D) : a.in[1] + ((size_t)sb * 64 + p) * D) + 4 * lane;
                    float ss = 0.f;
#pragma unroll
                    for (int j = 0; j < 4; ++j) { h[j] = *(const f32x4*)(xr + 256 * j); ss += (h[j][0] * h[j][0] + h[j][1] * h[j][1]) + (h[j][2] * h[j][2] + h[j][3] * h[j][3]); }
                    const float rstd = 1.0f / sqrtf(wave_sum(ss) * (1.0f / D) + EPS);
#pragma unroll
                    for (int j = 0; j < 4; ++j) h[j] = h[j] * rstd * g0[j];
                }
                r0[i & 1] = h[0]; r1[i & 3] = h[1]; r2[i & 7] = h[2]; r3[i] = h[3];
                if (s >= 15) {
                    f32x4 s0 = r0[0] + r0[1];
                    f32x4 s1 = (r1[0] + r1[1]) + (r1[2] + r1[3]);
                    f32x4 s2 = ((r2[0] + r2[1]) + (r2[2] + r2[3])) + ((r2[4] + r2[5]) + (r2[6] + r2[7]));
                    f32x4 s3 = (((r3[0] + r3[1]) + (r3[2] + r3[3])) + ((r3[4] + r3[5]) + (r3[6] + r3[7]))) + (((r3[8] + r3[9]) + (r3[10] + r3[11])) + ((r3[12] + r3[13]) + (r3[14] + r3[15])));
                    const int pc = prompt ? p + 1 : 16;
                    const float i0 = 1.0f / (float)(pc < 2 ? pc : 2), i1 = 1.0f / (float)(pc < 4 ? pc : 4), i2 = 1.0f / (float)(pc < 8 ? pc : 8), i3 = 1.0f / (float)(pc < 16 ? pc : 16);
                    s0 = s0 * i0 - h[0]; s1 = s1 * i1 - h[1]; s2 = s2 * i2 - h[2]; s3 = s3 * i3 - h[3];
                    bf16* drow = D0 + (size_t)(frow0 + s - 15) * D + 4 * lane;
                    v2u w; w.x = pk2(s0[0], s0[1]); w.y = pk2(s0[2], s0[3]); *(v2u*)(drow) = w;
                    w.x = pk2(s1[0], s1[1]); w.y = pk2(s1[2], s1[3]); *(v2u*)(drow + 256) = w;
                    w.x = pk2(s2[0], s2[1]); w.y = pk2(s2[2], s2[3]); *(v2u*)(drow + 512) = w;
                    w.x = pk2(s3[0], s3[1]); w.y = pk2(s3[2], s3[3]); *(v2u*)(drow + 768) = w;
                    const int L = prompt ? NPROMPT : NSAMP_L;
                    if (p >= L - 15) {
                        float* o = a.out + (prompt ? O_NPP : O_NPS + (size_t)sb * 15 * D) + (size_t)(p - (L - 15)) * D + 4 * lane;
#pragma unroll
                        for (int j = 0; j < 4; ++j) *(f32x4*)(o + 256 * j) = h[j];
                    }
                }
            }
        }
    }
}

__global__ void __launch_bounds__(512, 2) mega_fwd(Args a) {
    extern __shared__ __attribute__((aligned(16))) unsigned char lds_raw[];
    cg::grid_group grid = cg::this_grid();
    LAS unsigned char* lds = (LAS unsigned char*)lds_raw;
    const int tid = threadIdx.x, lane = tid & 63, wave = __builtin_amdgcn_readfirstlane(tid >> 6);
    const int G = gridDim.x, bx = blockIdx.x;
    const int vcu = (G % 8 == 0) ? (bx % 8) * (G / 8) + bx / 8 : bx;
    unsigned char* ws = a.ws;
    float* SS = (float*)(ws + WS_SS); float* XMETA = (float*)(ws + WS_XMETA);
    bf16* WPOOL = (bf16*)(ws + WS_WPOOL); bf16* WCO = (bf16*)(ws + WS_WCO); bf16* WCI = (bf16*)(ws + WS_WCI); bf16* WUP = (bf16*)(ws + WS_WUP); bf16* WDN = (bf16*)(ws + WS_WDN);
    bf16* XB = (bf16*)(ws + WS_XB); bf16* HB = (bf16*)(ws + WS_H); bf16* D0 = HB; bf16* ZB = HB; bf16* GB = (bf16*)(ws + WS_G);
    const int gw = vcu * 8 + wave, NGW = G * 8;

    {
        LAS float* scr = (LAS float*)(lds + wave * 16384);
        constexpr int I_POOL = 4 * 8, I_CO = 16 * 32, I_CI = 16 * 96, I_UP = 16 * 128, I_DN = 64 * 32;
        constexpr int NITEMS = 4 * I_POOL + I_CO + I_CI + 2 * I_UP + 2 * I_DN;
        for (int c = gw; c < NPROMPT / 16 + NSAMP_B * 4; c += NGW) pool_front_chunk(a, D0, c, lane);
        for (int it = gw; it < NITEMS; it += NGW) {
            int r = it;
            if (r < 4 * I_POOL) { const int g = r / I_POOL; p0_transpose_item(a.in[8] + (size_t)g * 65536, nullptr, 256, 256, WPOOL + (size_t)g * 65536, scr, r % I_POOL, lane); continue; } r -= 4 * I_POOL;
            if (r < I_CO) { p0_transpose_item(a.in[12], nullptr, D, D, WCO, scr, r, lane); continue; } r -= I_CO;
            if (r < I_CI) { p0_transpose_item(a.in[10], a.in[5] + D, D, 3 * D, WCI, scr, r, lane); continue; } r -= I_CI;
            if (r < 2 * I_UP) { const int l = r / I_UP; p0_transpose_item(a.in[13] + (size_t)l * D * FF, a.in[6] + l * D, D, FF, WUP + (size_t)l * D * FF, scr, r % I_UP, lane); continue; } r -= 2 * I_UP;
            { const int l = r / I_DN; p0_transpose_item(a.in[14] + (size_t)l * D * FF, nullptr, FF, D, WDN + (size_t)l * D * FF, scr, r % I_DN, lane); }
        }
        for (int i = bx * 512 + tid; i < (M_PAD - T_ROWS) * D / 8; i += G * 512) *(v4u*)(D0 + (size_t)T_ROWS * D + (size_t)i * 8) = (v4u){0u, 0u, 0u, 0u};
    }
    grid.sync();

    {
        pg8::Gemm g{D0, WPOOL, M_PAD, D, 256, D, 256, 256}; pg8::StaticOrder S; S.init(M_PAD, D, G, bx);
        pg8::EpiRes<true> E{XMETA, a.out, XB, SS, a.in[9], a.in[4], a.in[0], a.in[1]};
        pg8::gemm_phase(lds, g, S, E);
    }
    grid.sync();
    for (int layer = 0; layer < 2; ++layer) {
        if (layer == 1) {
            {
                pg8::Gemm g{XB, WCI, M_PAD, 3 * D, D, D, D, 0}; pg8::StaticOrder S; S.init(M_PAD, 3 * D, G, bx);
                pg8::EpiScaleBf16<0> E{ZB, 3 * D, SS};
                pg8::gemm_phase(lds, g, S, E);
            }
            grid.sync();
            {
                const float* cw = a.in[11]; const float* sc = a.in[3];
                const int q = tid & 127, ch = q * 8;
                float w0[8], w1[8], w2[8];
#pragma unroll
                for (int j = 0; j < 8; ++j) { w0[j] = cw[ch + j]; w1[j] = cw[D + ch + j]; w2[j] = cw[2 * D + ch + j]; }
                for (int row = vcu * 4 + (tid >> 7); row < M_PAD; row += G * 4) {
                    v4u o = (v4u){0u, 0u, 0u, 0u};
                    if (row < T_ROWS) {
                        const bool prompt = row < NPROMPT; const int sb = (row - NPROMPT) >> 6; const int pos = prompt ? row : (row - NPROMPT) & 63;
                        float y[8];
#pragma unroll
                        for (int j = 0; j < 8; ++j) y[j] = 0.f;
                        float ucur[8];
#pragma unroll
                        for (int k = 0; k < 3; ++k) {
                            const int p = pos - 2 + k; float u[8];
                            if (p >= 0) {
                                const bf16* zr = ZB + (size_t)(row - 2 + k) * (3 * D) + ch;
                                const v4u cv = *(const v4u*)(zr + D), vv = *(const v4u*)(zr + 2 * D);
                                u[0] = bf_lo(cv.x) * bf_lo(vv.x); u[1] = bf_hi(cv.x) * bf_hi(vv.x); u[2] = bf_lo(cv.y) * bf_lo(vv.y); u[3] = bf_hi(cv.y) * bf_hi(vv.y);
                                u[4] = bf_lo(cv.z) * bf_lo(vv.z); u[5] = bf_hi(cv.z) * bf_hi(vv.z); u[6] = bf_lo(cv.w) * bf_lo(vv.w); u[7] = bf_hi(cv.w) * bf_hi(vv.w);
                            } else if (!prompt) {
                                const float* hp = sc + ((size_t)sb * 2 + (p + 2)) * D + ch; const f32x4 h0 = *(const f32x4*)hp, h1 = *(const f32x4*)(hp + 4);
                                u[0] = h0[0]; u[1] = h0[1]; u[2] = h0[2]; u[3] = h0[3]; u[4] = h1[0]; u[5] = h1[1]; u[6] = h1[2]; u[7] = h1[3];
                            } else {
#pragma unroll
                                for (int j = 0; j < 8; ++j) u[j] = 0.f;
                            }
#pragma unroll
                            for (int j = 0; j < 8; ++j) { y[j] += (k == 0 ? w0[j] : (k == 1 ? w1[j] : w2[j])) * u[j]; if (k == 2) ucur[j] = u[j]; }
                        }
                        const v4u bv = *(const v4u*)(ZB + (size_t)row * (3 * D) + ch);
                        o.x = pk2(bf_lo(bv.x) * y[0], bf_hi(bv.x) * y[1]); o.y = pk2(bf_lo(bv.y) * y[2], bf_hi(bv.y) * y[3]);
                        o.z = pk2(bf_lo(bv.z) * y[4], bf_hi(bv.z) * y[5]); o.w = pk2(bf_lo(bv.w) * y[6], bf_hi(bv.w) * y[7]);
                        const int L = prompt ? NPROMPT : NSAMP_L;
                        if (pos >= L - 2) {
                            float* op = a.out + (prompt ? O_NCP : O_NCS + (size_t)sb * 2 * D) + (size_t)(pos - (L - 2)) * D + ch;
                            *(f32x4*)op = (f32x4){ucur[0], ucur[1], ucur[2], ucur[3]}; *(f32x4*)(op + 4) = (f32x4){ucur[4], ucur[5], ucur[6], ucur[7]};
                        }
                    }
                    *(v4u*)(GB + (size_t)row * D + ch) = o;
                }
            }
            grid.sync();
            {
                pg8::Gemm g{GB, WCO, M_PAD, D, D, D, D, 0}; pg8::StaticOrder S; S.init(M_PAD, D, G, bx);
                pg8::EpiRes<false> E{XMETA, a.out, XB, SS, nullptr, nullptr, nullptr, nullptr};
                pg8::gemm_phase(lds, g, S, E);
            }
            grid.sync();
        }
        {
            pg8::Gemm g{XB, WUP + (size_t)layer * D * FF, M_PAD, FF, D, D, D, 0}; pg8::StaticOrder S; S.init(M_PAD, FF, G, bx);
            pg8::EpiScaleBf16<1> E{HB, FF, SS};
            pg8::gemm_phase(lds, g, S, E);
        }
        grid.sync();
        {
            pg8::Gemm g{HB, WDN + (size_t)layer * D * FF, M_PAD, D, FF, FF, FF, 0}; pg8::StaticOrder S; S.init(M_PAD, D, G, bx);
            pg8::EpiRes<false> E{XMETA, a.out, XB, SS, nullptr, nullptr, nullptr, nullptr};
            pg8::gemm_phase(lds, g, S, E);
        }
        grid.sync();
    }
    {
        const float* gf = a.in[7];
        f32x4 gv[4];
#pragma unroll
        for (int j = 0; j < 4; ++j) gv[j] = *(const f32x4*)(gf + 4 * lane + 256 * j);
        for (int row = 16 + gw; row < T_ROWS; row += NGW) {
            const float rs = pg8::row_rstd(SS, row);
            float* xr = a.out + (size_t)(row - 16) * D + 4 * lane;
#pragma unroll
            for (int j = 0; j < 4; ++j) { f32x4 v = *(const f32x4*)(xr + 256 * j); v = v * rs * gv[j]; *(f32x4*)(xr + 256 * j) = v; }
        }
    }
}

extern "C" void kernel_launch(void* const* d_in, const int* in_sizes, int n_in, void* d_out, int out_size, void* d_ws, size_t ws_size, hipStream_t stream) {
    static int grid = 0;
    if (grid == 0) {
        if (n_in != 15 || ws_size < WS_END) { fprintf(stderr, "kernel_launch: unexpected n_in %d / ws %zu (need %zu)\n", n_in, ws_size, (size_t)WS_END); grid = -1; return; }
        int dev = 0, cus = 0, per_cu = 0;
        hipGetDevice(&dev); hipDeviceGetAttribute(&cus, hipDeviceAttributeMultiprocessorCount, dev);
        if (hipFuncSetAttribute((const void*)mega_fwd, hipFuncAttributeMaxDynamicSharedMemorySize, LDS_BYTES) != hipSuccess) { fprintf(stderr, "kernel_launch: hipFuncSetAttribute failed\n"); grid = -1; return; }
        if (hipOccupancyMaxActiveBlocksPerMultiprocessor(&per_cu, (const void*)mega_fwd, 512, LDS_BYTES) != hipSuccess || per_cu < 1) { fprintf(stderr, "kernel_launch: occupancy query says %d\n", per_cu); per_cu = 1; }
        (void)hipGetLastError();
        grid = cus * 1;
        fprintf(stderr, "kernel_launch: grid %d (cus %d, per_cu %d)\n", grid, cus, per_cu);
    }
    if (grid < 0) return;
    Args a{};
    for (int i = 0; i < 15; ++i) a.in[i] = (const float*)d_in[i];
    a.out = (float*)d_out; a.ws = (unsigned char*)d_ws;
    void* args[] = {&a};
    hipError_t e = hipLaunchCooperativeKernel((const void*)mega_fwd, dim3(grid), dim3(512), args, LDS_BYTES, stream);
    if (e != hipSuccess) fprintf(stderr, "cooperative launch failed: %s (grid %d)\n", hipGetErrorString(e), grid);
}
```
